# Optimizing an MI355X kernel written in HIP

```python
import jax, jax.numpy as jnp
from jax import lax
import numpy as np

D_MODEL = 1024
BATCH = 4
SEQ = 8192
DEPTH = 1

CHUNK = 64
WIDTH_A = D_MODEL
A_GROUPS = 8
A_GROUP_DIM = WIDTH_A // A_GROUPS
SPATIAL_CHUNK = 128
WIDTH_B = D_MODEL
B_GROUPS = 8
CONV_WIDTH = 3
SEG_WIDTHS = [WIDTH_A, WIDTH_A, WIDTH_A,
              WIDTH_B, WIDTH_B, WIDTH_B, WIDTH_B,
              D_MODEL, D_MODEL]
PROJ_WIDTH = int(sum(SEG_WIDTHS))
SPLIT_POINTS = [int(v) for v in np.cumsum(SEG_WIDTHS)[:-1]]
EPS = 1e-6

kernel_name = "hybrid_gmlp_shortconv_gated_block"


def rmsnorm(x, g):
    xf = x.astype(jnp.float32)
    r = lax.rsqrt(jnp.mean(xf * xf, axis=-1, keepdims=True) + EPS)
    return (xf * r).astype(x.dtype) * g


def spatial_gating(u, v, v_norm_g, w_spatial, b_spatial):
    bsz, seq, _ = v.shape
    n_chunks = seq // SPATIAL_CHUNK
    u = jax.nn.gelu(u, approximate=False)
    v = rmsnorm(jax.nn.gelu(v, approximate=False), v_norm_g)
    v = v.reshape(bsz, n_chunks, SPATIAL_CHUNK, A_GROUPS, A_GROUP_DIM)
    tril = jnp.tril(jnp.ones((SPATIAL_CHUNK, SPATIAL_CHUNK), dtype=bool))
    w_s = jnp.where(tril[None], w_spatial, jnp.zeros((), w_spatial.dtype))
    mixed = jnp.einsum('gts,bnsgc->bntgc', w_s, v) + b_spatial.T[None, None, :, :, None]
    return u * mixed.reshape(bsz, seq, WIDTH_A)


def short_gated_conv(x_b, c_b, b_b, conv_w):
    seq = x_b.shape[1]
    hc = c_b * x_b
    padded = jnp.pad(hc, ((0, 0), (CONV_WIDTH - 1, 0), (0, 0)))
    conv = padded[:, 0:seq, :] * conv_w[0]
    for k in range(1, CONV_WIDTH):
        conv = conv + padded[:, k:k + seq, :] * conv_w[k]
    return b_b * conv


def setup_inputs(seed: int = 0) -> dict:
    key = jax.random.key(seed)
    ks = jax.random.split(key, 11)
    x = jax.random.normal(ks[0], (BATCH, SEQ, D_MODEL), jnp.float32)
    norm_g = 1.0 + 0.02 * jax.random.normal(ks[1], (DEPTH, D_MODEL), jnp.float32)
    w_in = jax.random.normal(ks[2], (DEPTH, D_MODEL, PROJ_WIDTH), jnp.float32) * D_MODEL ** -0.5
    v_norm_g = 1.0 + 0.02 * jax.random.normal(ks[3], (DEPTH, WIDTH_A), jnp.float32)
    w_spatial = jax.random.normal(ks[4], (DEPTH, A_GROUPS, SPATIAL_CHUNK, SPATIAL_CHUNK), jnp.float32) * (0.5 * SPATIAL_CHUNK ** -0.5)
    b_spatial = 1.0 + 0.02 * jax.random.normal(ks[5], (DEPTH, A_GROUPS, SPATIAL_CHUNK), jnp.float32)
    conv_w = jax.random.normal(ks[6], (DEPTH, CONV_WIDTH, WIDTH_B), jnp.float32) * CONV_WIDTH ** -0.5
    w_branch_a = jax.random.normal(ks[7], (DEPTH, WIDTH_A, D_MODEL), jnp.float32) * WIDTH_A ** -0.5
    w_branch_b = jax.random.normal(ks[8], (DEPTH, WIDTH_B, D_MODEL), jnp.float32) * WIDTH_B ** -0.5
    w_out = jax.random.normal(ks[9], (DEPTH, D_MODEL, D_MODEL), jnp.float32) * D_MODEL ** -0.5
    final_norm_g = 1.0 + 0.02 * jax.random.normal(ks[10], (D_MODEL,), jnp.float32)
    return {"x": x, "norm_g": norm_g, "w_in": w_in, "v_norm_g": v_norm_g,
            "w_spatial": w_spatial, "b_spatial": b_spatial, "conv_w": conv_w,
            "w_branch_a": w_branch_a, "w_branch_b": w_branch_b, "w_out": w_out,
            "final_norm_g": final_norm_g}


def reference(x, norm_g, w_in, v_norm_g, w_spatial, b_spatial, conv_w,
              w_branch_a, w_branch_b, w_out, final_norm_g):
    for layer in range(DEPTH):
        h = rmsnorm(x, norm_g[layer])
        proj = jnp.einsum('bsd,de->bse', h, w_in[layer])
        u_a, v_a, z_a, x_b, c_b, b_b, z_b, g_a, g_b = jnp.split(proj, SPLIT_POINTS, axis=-1)
        y_a = spatial_gating(u_a, v_a, v_norm_g[layer], w_spatial[layer], b_spatial[layer]) * jax.nn.silu(z_a)
        y_b = short_gated_conv(x_b, c_b, b_b, conv_w[layer]) * jax.nn.silu(z_b)
        ya_d = jnp.einsum('bse,ed->bsd', y_a, w_branch_a[layer])
        yb_d = jnp.einsum('bse,ed->bsd', y_b, w_branch_b[layer])
        merged = jax.nn.sigmoid(g_a) * ya_d + jax.nn.sigmoid(g_b) * yb_d
        x = x + jnp.einsum('bsd,de->bse', merged, w_out[layer])
    return rmsnorm(x, final_norm_g)
```

```cpp
#include <hip/hip_runtime.h>
#include <hip/hip_cooperative_groups.h>
#include <cstdio>
#include <cstdint>
namespace cg = cooperative_groups;

#ifndef MK_N_LAUNCHES
#define MK_N_LAUNCHES 1
#endif

namespace pg8 {
#define PG8_LAS __attribute__((address_space(3)))
typedef unsigned short bf16_t;
typedef short bf16x8 __attribute__((ext_vector_type(8)));
typedef float f32x4 __attribute__((ext_vector_type(4)));
typedef float f32x2 __attribute__((ext_vector_type(2)));
typedef unsigned u32x4 __attribute__((ext_vector_type(4)));
typedef unsigned u32x2 __attribute__((ext_vector_type(2)));
constexpr int BM = 256, BK = 64, HALF = 128, HTB = HALF * BK * 2, STAGE_BYTES = 8 * HTB, NXCD = 8, WGM = 8;

__host__ __device__ __forceinline__ int lds_byte(int r, int c) { const int st = (r >> 4) * 2 + (c >> 5), rr = r & 15, cc = c & 31, ob = rr * 64 + cc * 2; return st * 1024 + (ob ^ (((ob >> 9) & 1) << 5)); }
__host__ __device__ __forceinline__ void stage_rc(int b, int& R, int& C) { const int st = b / 1024, sb = b % 1024, swz = sb ^ (((sb >> 9) & 1) << 5); R = (st >> 1) * 16 + swz / 64; C = (st & 1) * 32 + (swz % 64) / 2; }
__host__ __device__ __forceinline__ int perm32(int rho) { const int n = rho >> 4, i = rho & 15; return 8 * (i >> 2) + 4 * n + (i & 3); }

struct Unit { int pm, pn; };
struct Gemm { const bf16_t* A; const bf16_t* Bt; int M, N, K, lda, ldb, ksplit; long asplit; };

struct StaticOrder {
    int nM, nN, nwg, G, c;
    __host__ __device__ void init(int M, int N, int G_, int c_) { nM = M / BM; nN = N / BM; nwg = nM * nN; G = G_; c = c_; }
    __host__ __device__ bool next(int i, Unit& u) const {
        const long L = (long)i * G + c; if (L >= nwg) return false;
        int wgid = (int)L; { const int q = nwg / NXCD, r = nwg % NXCD, xcd = wgid % NXCD, off = wgid / NXCD; wgid = (xcd < r ? xcd * (q + 1) : r * (q + 1) + (xcd - r) * q) + off; }
        const int nig = WGM * nN, gid = wgid / nig, fm = gid * WGM, gsz = (nM - fm) < WGM ? (nM - fm) : WGM;
        u.pm = fm + ((wgid % nig) % gsz); u.pn = (wgid % nig) / gsz; return true;
    }
};

__device__ __forceinline__ unsigned cvt_pk_bf16(float lo, float hi) { unsigned r; asm volatile("v_cvt_pk_bf16_f32 %0, %1, %2" : "=v"(r) : "v"(lo), "v"(hi)); return r; }
__device__ __forceinline__ float bf_lo(unsigned w) { return __builtin_bit_cast(float, w << 16); }
__device__ __forceinline__ float bf_hi(unsigned w) { return __builtin_bit_cast(float, w & 0xffff0000u); }
__device__ __forceinline__ f32x2 gelu_pk(f32x2 v) {
    const f32x2 av = __builtin_elementwise_abs(v), d = av * 0.2316418882f + 1.0f;
    f32x2 t; t.x = __builtin_amdgcn_rcpf(d.x); t.y = __builtin_amdgcn_rcpf(d.y);
    f32x2 q = t * 0.5307027145f + (-0.7265760135f); q = q * t + 0.7107068705f; q = q * t + (-0.142248368f); q = q * t + 0.127414796f; q = q * t;
    const f32x2 s = (v * v) * (-0.72134752044f);
    f32x2 e; e.x = __builtin_amdgcn_exp2f(s.x); e.y = __builtin_amdgcn_exp2f(s.y);
    const f32x2 m = v * (q * e), r = v - m;
    f32x2 o; o.x = v.x < 0.f ? m.x : r.x; o.y = v.y < 0.f ? m.y : r.y; return o;
}
__device__ __forceinline__ float sigmoid_f(float z) { return __builtin_amdgcn_rcpf(1.0f + __builtin_amdgcn_exp2f(z * -1.44269504089f)); }
__device__ __forceinline__ float silu_f(float z) { return z * sigmoid_f(z); }
template <class T> __device__ __forceinline__ T ldg(const void* base, unsigned off) { return *(const T*)((const char*)base + off); }
template <class T> __device__ __forceinline__ void stg(void* base, unsigned off, T v) { *(T*)((char*)base + off) = v; }
__device__ __forceinline__ int launder(int v) { asm volatile("" : "+v"(v)); return v; }
__device__ __forceinline__ int lane_id() { int l; asm volatile("v_mbcnt_lo_u32_b32 %0, -1, 0\n\tv_mbcnt_hi_u32_b32 %0, -1, %0" : "=v"(l)); return l; }

template <class Epi, class Sched, bool ALIGN_EPI = true, bool SP2 = true>
__device__ __forceinline__ void gemm_phase(PG8_LAS unsigned char* lds, const int wid, const Gemm g, const Sched& S, const Epi& E) {
    const int lane = lane_id(), tid = wid * 64 + lane, wr = wid >> 2, wc = wid & 3, fr = lane & 15, fq = lane >> 4;
    const int nt = g.K / BK;
    unsigned voffA[2], voffB[2];
#pragma unroll
    for (int i = 0; i < 2; ++i) { int R, C; stage_rc(tid * 16 + i * 8192, R, C);
        voffA[i] = (unsigned)(R * g.lda + C) * 2u; voffB[i] = (unsigned)(R * g.ldb + C) * 2u; }
    const size_t kstep = (size_t)(BK * 2);
    const size_t hstepA = (size_t)HALF * g.lda * 2, hstepB = (size_t)HALF * g.ldb * 2;
    const size_t tstepA = 2 * hstepA, tstepB = 2 * hstepB;
    const unsigned ldsw = (unsigned)wid * 1024u;
    const int aoff = lds_byte(wr * 64 + fr, fq * 8), boff = lds_byte(wc * 32 + fr, fq * 8);
    const int ksplit = g.ksplit; const long asplit = g.asplit;
#define PG8_AP(base, tt) ((base) + (size_t)(tt) * kstep + ((tt) >= ksplit ? asplit : 0l))
#define PG8_SA(b, h) (((b) * 2 + (h)) * HTB)
#define PG8_SB(b, h) ((4 + (b) * 2 + (h)) * HTB)
#define PG8_STAGE(bufoff, gbase, voff) do { _Pragma("unroll") for (int _i = 0; _i < 2; ++_i) \
        __builtin_amdgcn_global_load_lds((const unsigned*)((const char*)(gbase) + (voff)[_i]), (PG8_LAS unsigned*)(lds + (bufoff) + ldsw + _i * 8192), 16, 0, 0); } while (0)
#define PG8_LDA(dst, b, h) do { _Pragma("unroll") for (int m = 0; m < 4; ++m) _Pragma("unroll") for (int k = 0; k < 2; ++k) dst[m][k] = *(const PG8_LAS bf16x8*)(lds + PG8_SA(b, h) + aoff + m * 2048 + k * 1024); } while (0)
#define PG8_LDB(dst, b, h) do { _Pragma("unroll") for (int n = 0; n < 2; ++n) _Pragma("unroll") for (int k = 0; k < 2; ++k) dst[n][k] = *(const PG8_LAS bf16x8*)(lds + PG8_SB(b, h) + boff + n * 2048 + k * 1024); } while (0)
#define PG8_MMA(ai, bj, At, Bt) do { __builtin_amdgcn_s_setprio(1); _Pragma("unroll") for (int m = 0; m < 4; ++m) _Pragma("unroll") for (int n = 0; n < 2; ++n) _Pragma("unroll") for (int k = 0; k < 2; ++k) \
        acc[ai][bj][m][n] = __builtin_amdgcn_mfma_f32_16x16x32_bf16(Bt[n][k], At[m][k], acc[ai][bj][m][n], 0, 0, 0); __builtin_amdgcn_s_setprio(0); } while (0)
#define PG8_WAIT_V(n) asm volatile("s_waitcnt vmcnt(" #n ")" ::: "memory")
#define PG8_WAIT_L(n) asm volatile("s_waitcnt lgkmcnt(" #n ")" ::: "memory")
#define PG8_BAR __builtin_amdgcn_s_barrier()
#define PG8_SCHED __builtin_amdgcn_sched_barrier(0)
    Unit cur, nxt; int ui = 0;
    if (!S.next(0, cur)) return;
    f32x4 acc[2][2][4][2];
#pragma unroll
    for (int a = 0; a < 2; ++a)
#pragma unroll
        for (int b = 0; b < 2; ++b)
#pragma unroll
            for (int m = 0; m < 4; ++m)
#pragma unroll
                for (int n = 0; n < 2; ++n) acc[a][b][m][n] = (f32x4){0.f, 0.f, 0.f, 0.f};
    bf16x8 At[4][2], B0[2][2], B1[2][2];
    const char* cA = (const char*)g.A + (size_t)cur.pm * tstepA; const char* cB = (const char*)g.Bt + (size_t)cur.pn * tstepB;
    if constexpr (SP2) {
        PG8_STAGE(PG8_SB(0, 0), cB, voffB); PG8_STAGE(PG8_SB(0, 1), cB + hstepB, voffB); PG8_STAGE(PG8_SA(0, 0), cA, voffA); PG8_STAGE(PG8_SA(0, 1), cA + hstepA, voffA);
        if (wr == 1) PG8_BAR;
        PG8_WAIT_V(2); PG8_BAR;
        PG8_STAGE(PG8_SB(1, 0), cB + kstep, voffB); PG8_STAGE(PG8_SA(1, 0), cA + kstep, voffA); PG8_STAGE(PG8_SB(1, 1), cB + hstepB + kstep, voffB);
        PG8_WAIT_V(6); PG8_BAR;
    } else {
        PG8_STAGE(PG8_SB(0, 0), cB, voffB); PG8_STAGE(PG8_SA(0, 0), cA, voffA); PG8_STAGE(PG8_SB(0, 1), cB + hstepB, voffB); PG8_STAGE(PG8_SA(0, 1), cA + hstepA, voffA);
        if (wr == 1) PG8_BAR;
        PG8_WAIT_V(4); PG8_BAR;
        PG8_STAGE(PG8_SB(1, 0), cB + kstep, voffB); PG8_STAGE(PG8_SA(1, 0), cA + kstep, voffA); PG8_STAGE(PG8_SB(1, 1), cB + hstepB + kstep, voffB);
        PG8_WAIT_V(6); PG8_BAR;
    }
    for (;;) {
        const bool has_next = S.next(ui + 1, nxt);
        const char* nA = has_next ? (const char*)g.A + (size_t)nxt.pm * tstepA : cA; const char* nB = has_next ? (const char*)g.Bt + (size_t)nxt.pn * tstepB : cB;
        for (int t = 0; t < nt; t += 2) {
            const bool last = (t == nt - 2);
            if constexpr (Epi::HAS_MID) { if (t == ksplit) E.mid(acc, cur, wr, wc, fr, fq); }
            const char* a1 = PG8_AP(cA, t + 1);
            const char* a2 = last ? nA : PG8_AP(cA, t + 2); const char* b2 = last ? nB : cB + (size_t)(t + 2) * kstep;
            const char* a3 = last ? nA + kstep : PG8_AP(cA, t + 3); const char* b3 = b2 + kstep;
            if constexpr (SP2) {
            PG8_LDB(B0, 0, 0); PG8_LDB(B1, 0, 1); PG8_SCHED; PG8_LDA(At, 0, 0); PG8_STAGE(PG8_SA(1, 1), a1 + hstepA, voffA);
            PG8_WAIT_V(8); PG8_WAIT_L(0); PG8_BAR; PG8_MMA(0, 0, At, B0); PG8_MMA(0, 1, At, B1); PG8_BAR; PG8_SCHED;
            PG8_LDA(At, 0, 1); PG8_STAGE(PG8_SB(0, 0), b2, voffB); PG8_STAGE(PG8_SB(0, 1), b2 + hstepB, voffB); PG8_STAGE(PG8_SA(0, 0), a2, voffA);
            PG8_WAIT_V(8); PG8_WAIT_L(0); PG8_BAR; PG8_MMA(1, 0, At, B0); PG8_MMA(1, 1, At, B1); PG8_BAR; PG8_SCHED;
            PG8_LDB(B0, 1, 0); PG8_LDB(B1, 1, 1); PG8_SCHED; PG8_LDA(At, 1, 0); PG8_STAGE(PG8_SA(0, 1), a2 + hstepA, voffA);
            PG8_WAIT_V(8); PG8_WAIT_L(0); PG8_BAR; PG8_MMA(0, 0, At, B0); PG8_MMA(0, 1, At, B1); PG8_BAR; PG8_SCHED;
            PG8_LDA(At, 1, 1); PG8_STAGE(PG8_SB(1, 0), b3, voffB); PG8_STAGE(PG8_SB(1, 1), b3 + hstepB, voffB); PG8_STAGE(PG8_SA(1, 0), a3, voffA);
            PG8_WAIT_V(8); PG8_WAIT_L(0); PG8_BAR; PG8_MMA(1, 0, At, B0); PG8_MMA(1, 1, At, B1); PG8_BAR; PG8_SCHED;
            } else {
            PG8_LDB(B0, 0, 0); PG8_SCHED; PG8_LDA(At, 0, 0); PG8_STAGE(PG8_SA(1, 1), a1 + hstepA, voffA);
            PG8_WAIT_L(8); PG8_BAR; PG8_WAIT_L(0); PG8_MMA(0, 0, At, B0); PG8_BAR; PG8_SCHED;
            PG8_LDB(B1, 0, 1); PG8_STAGE(PG8_SB(0, 0), b2, voffB);
            PG8_BAR; PG8_WAIT_L(0); PG8_MMA(0, 1, At, B1); PG8_BAR;
            PG8_LDA(At, 0, 1); PG8_STAGE(PG8_SA(0, 0), a2, voffA);
            PG8_BAR; PG8_WAIT_L(0); PG8_MMA(1, 0, At, B0); PG8_BAR; PG8_SCHED;
            PG8_STAGE(PG8_SB(0, 1), b2 + hstepB, voffB);
            PG8_WAIT_V(6); PG8_BAR; PG8_MMA(1, 1, At, B1); PG8_BAR;
            PG8_LDB(B0, 1, 0); PG8_SCHED; PG8_LDA(At, 1, 0); PG8_STAGE(PG8_SA(0, 1), a2 + hstepA, voffA);
            PG8_WAIT_L(8); PG8_BAR; PG8_WAIT_L(0); PG8_MMA(0, 0, At, B0); PG8_BAR; PG8_SCHED;
            PG8_LDB(B1, 1, 1); PG8_STAGE(PG8_SB(1, 0), b3, voffB);
            PG8_BAR; PG8_WAIT_L(0); PG8_MMA(0, 1, At, B1); PG8_BAR;
            PG8_LDA(At, 1, 1); PG8_STAGE(PG8_SA(1, 0), a3, voffA);
            PG8_BAR; PG8_WAIT_L(0); PG8_MMA(1, 0, At, B0); PG8_BAR; PG8_SCHED;
            PG8_STAGE(PG8_SB(1, 1), b3 + hstepB, voffB);
            PG8_WAIT_V(6); PG8_BAR; PG8_MMA(1, 1, At, B1); PG8_BAR;
            }
        }
        if constexpr (ALIGN_EPI) { if (wr == 0) PG8_BAR; }
        E(acc, cur, wr, wc, fr, fq);
        if (!has_next) break;
#pragma unroll
        for (int a = 0; a < 2; ++a)
#pragma unroll
            for (int b = 0; b < 2; ++b)
#pragma unroll
                for (int m = 0; m < 4; ++m)
#pragma unroll
                    for (int n = 0; n < 2; ++n) acc[a][b][m][n] = (f32x4){0.f, 0.f, 0.f, 0.f};
        cur = nxt; cA = nA; cB = nB; ++ui;
        if constexpr (ALIGN_EPI) { if (wr == 1) PG8_BAR; }
    }
    PG8_WAIT_V(0);
    if constexpr (!ALIGN_EPI) { if (wr == 0) PG8_BAR; }
    PG8_BAR;
#undef PG8_AP
#undef PG8_SA
#undef PG8_SB
#undef PG8_STAGE
#undef PG8_LDA
#undef PG8_LDB
#undef PG8_MMA
#undef PG8_WAIT_V
#undef PG8_WAIT_L
#undef PG8_BAR
#undef PG8_SCHED
}
}

using pg8::bf16_t; using pg8::bf16x8; using pg8::f32x4; using pg8::f32x2; using pg8::u32x4; using pg8::u32x2; using pg8::Unit;
using pg8::cvt_pk_bf16; using pg8::bf_lo; using pg8::bf_hi; using pg8::gelu_pk; using pg8::sigmoid_f; using pg8::silu_f;
#define LAS __attribute__((address_space(3)))

constexpr int BATCH = 4, SEQ = 8192, D = 1024, M = BATCH * SEQ, NPROJ = 9 * D, NGRP = 8, GDIM = 128, SCH = 128;
constexpr float EPS = 1e-6f;
constexpr size_t MiB = 1u << 20;
constexpr size_t WS_W1T = 1 * MiB;
constexpr size_t WS_B2T = 19 * MiB;
constexpr size_t WS_WOT = 23 * MiB;
constexpr size_t WS_WSB = 25 * MiB;
constexpr size_t WS_RINV = 26 * MiB;
constexpr size_t WS_VSS = 27 * MiB;
constexpr size_t WS_OSS = 29 * MiB;
constexpr size_t WS_XB = 32 * MiB;
constexpr size_t WS_UZ = 96 * MiB;
constexpr size_t WS_BZ = 160 * MiB;
constexpr size_t WS_GV = 224 * MiB;
constexpr size_t WS_HC = 288 * MiB;
constexpr size_t WS_SA = 352 * MiB;
constexpr size_t WS_SB = 416 * MiB;
constexpr size_t WS_END = 480 * MiB;
constexpr int LDS_BYTES = 131072 + 512;

using pg8::ldg; using pg8::stg; using pg8::launder;
template <int TYPE>
__device__ __forceinline__ void pair_rows(const f32x4 (&acc)[2][2][4][2], bf16_t* O, const float* rinv, int row0, int ch) {
    const unsigned ob = (unsigned)row0 * (D * 2) + (unsigned)ch * 2, rb = (unsigned)row0 * 4;
#pragma unroll
    for (int ai = 0; ai < 2; ++ai)
#pragma unroll
        for (int m = 0; m < 4; ++m) {
            const float rr = ldg<float>(rinv, rb + (ai * 128 + m * 16) * 4);
            u32x4 w;
#pragma unroll
            for (int n = 0; n < 2; ++n) {
                const f32x4 a = acc[ai][0][m][n] * rr, b = acc[ai][1][m][n] * rr; f32x4 o;
                if (TYPE == 0) { const f32x2 g0 = gelu_pk((f32x2){a[0], a[1]}), g1 = gelu_pk((f32x2){a[2], a[3]});
                    o = (f32x4){g0.x * silu_f(b[0]), g0.y * silu_f(b[1]), g1.x * silu_f(b[2]), g1.y * silu_f(b[3])}; }
                else if (TYPE == 1) o = a * b;
                else o = (f32x4){a[0] * silu_f(b[0]), a[1] * silu_f(b[1]), a[2] * silu_f(b[2]), a[3] * silu_f(b[3])};
                w[2 * n] = cvt_pk_bf16(o[0], o[1]); w[2 * n + 1] = cvt_pk_bf16(o[2], o[3]);
            }
            stg<u32x4>(O, ob + (unsigned)(ai * 128 + m * 16) * (D * 2), w);
        }
}
template <int TYPE>
__device__ __forceinline__ void single_rows(const f32x4 (&acc)[2][2][4][2], bf16_t* O, const float* rinv, float* vss, int row0, int ch0, int slot, int fq) {
    const unsigned ob = (unsigned)row0 * (D * 2) + (unsigned)ch0 * 2, rb = (unsigned)row0 * 4, sb = (unsigned)row0 * 64 + (unsigned)slot * 4;
#pragma unroll
    for (int ai = 0; ai < 2; ++ai)
#pragma unroll
        for (int m = 0; m < 4; ++m) {
            const float rr = ldg<float>(rinv, rb + (ai * 128 + m * 16) * 4); float ss = 0.f;
#pragma unroll
            for (int bj = 0; bj < 2; ++bj) { u32x4 w;
#pragma unroll
                for (int n = 0; n < 2; ++n) {
                    const f32x4 v = acc[ai][bj][m][n] * rr; f32x4 o;
                    if (TYPE == 0) { const f32x2 g0 = gelu_pk((f32x2){v[0], v[1]}), g1 = gelu_pk((f32x2){v[2], v[3]}); o = (f32x4){g0.x, g0.y, g1.x, g1.y};
                        ss += (o[0] * o[0] + o[1] * o[1]) + (o[2] * o[2] + o[3] * o[3]); }
                    else o = (f32x4){sigmoid_f(v[0]), sigmoid_f(v[1]), sigmoid_f(v[2]), sigmoid_f(v[3])};
                    w[2 * n] = cvt_pk_bf16(o[0], o[1]); w[2 * n + 1] = cvt_pk_bf16(o[2], o[3]);
                }
                stg<u32x4>(O, ob + (unsigned)(ai * 128 + m * 16) * (D * 2) + 256 * bj, w); }
            if (TYPE == 0) { ss += __shfl_xor(ss, 16); ss += __shfl_xor(ss, 32); if (fq == 0) stg<float>(vss, sb + (ai * 128 + m * 16) * 64, ss); }
        }
}
struct EpiProj {
    static constexpr bool HAS_MID = false;
    const float* rinv; bf16_t *UZ, *GV, *HC, *BZ, *SA, *SB; float* vss;
    __device__ __forceinline__ void operator()(const f32x4 (&acc)[2][2][4][2], const Unit& u, int wr, int wc, int fr_, int fq_) const {
        const int fr = launder(fr_), fq = launder(fq_);
        const int pn = u.pn, row0 = u.pm * 256 + wr * 64 + fr;
        if (pn < 24) {
            const int type = pn >> 3, ch = 128 * (pn & 7) + 32 * wc + 8 * fq;
            if (type == 0) pair_rows<0>(acc, UZ, rinv, row0, ch);
            else if (type == 1) pair_rows<1>(acc, HC, rinv, row0, ch);
            else pair_rows<2>(acc, BZ, rinv, row0, ch);
        } else {
            const int s = (pn - 24) >> 2, trel = (pn - 24) & 3, ch0 = 256 * trel + 32 * wc + 8 * fq;
            if (s == 0) single_rows<0>(acc, GV, rinv, vss, row0, ch0, trel * 4 + wc, fq);
            else single_rows<1>(acc, s == 1 ? SA : SB, rinv, vss, row0, ch0, 0, fq);
        }
    }
    __device__ __forceinline__ void mid(f32x4 (&)[2][2][4][2], const Unit&, int, int, int, int) const {}
};
struct EpiMerge {
    static constexpr bool HAS_MID = true;
    const bf16_t *SA, *SB; bf16_t* MG;
    __device__ __forceinline__ void mid(f32x4 (&acc)[2][2][4][2], const Unit& u, int wr, int wc, int fr_, int fq_) const {
        const int fr = launder(fr_), fq = launder(fq_);
        const unsigned ob = (unsigned)(u.pm * 256 + wr * 64 + fr) * (D * 2) + (unsigned)(u.pn * 256 + 32 * wc + 8 * fq) * 2;
#pragma unroll
        for (int ai = 0; ai < 2; ++ai)
#pragma unroll
            for (int m = 0; m < 4; ++m) { const unsigned ro = ob + (unsigned)(ai * 128 + m * 16) * (D * 2);
#pragma unroll
                for (int bj = 0; bj < 2; ++bj) { const u32x4 a = ldg<u32x4>(SA, ro + 256 * bj), b = ldg<u32x4>(SB, ro + 256 * bj);
#pragma unroll
                    for (int n = 0; n < 2; ++n) { f32x4 q;
                        q[0] = bf_lo(a[2 * n]) * __builtin_amdgcn_rcpf(bf_lo(b[2 * n])); q[1] = bf_hi(a[2 * n]) * __builtin_amdgcn_rcpf(bf_hi(b[2 * n]));
                        q[2] = bf_lo(a[2 * n + 1]) * __builtin_amdgcn_rcpf(bf_lo(b[2 * n + 1])); q[3] = bf_hi(a[2 * n + 1]) * __builtin_amdgcn_rcpf(bf_hi(b[2 * n + 1]));
                        acc[ai][bj][m][n] *= q; } }
                asm volatile("" ::: "memory"); }
    }
    __device__ __forceinline__ void operator()(const f32x4 (&acc)[2][2][4][2], const Unit& u, int wr, int wc, int fr_, int fq_) const {
        const int fr = launder(fr_), fq = launder(fq_);
        const unsigned ob = (unsigned)(u.pm * 256 + wr * 64 + fr) * (D * 2) + (unsigned)(u.pn * 256 + 32 * wc + 8 * fq) * 2;
#pragma unroll
        for (int ai = 0; ai < 2; ++ai)
#pragma unroll
            for (int m = 0; m < 4; ++m) { const unsigned ro = ob + (unsigned)(ai * 128 + m * 16) * (D * 2);
#pragma unroll
                for (int bj = 0; bj < 2; ++bj) { const u32x4 b = ldg<u32x4>(SB, ro + 256 * bj); u32x4 w;
#pragma unroll
                    for (int n = 0; n < 2; ++n) { const f32x4 v = acc[ai][bj][m][n];
                        w[2 * n] = cvt_pk_bf16(v[0] * bf_lo(b[2 * n]), v[1] * bf_hi(b[2 * n])); w[2 * n + 1] = cvt_pk_bf16(v[2] * bf_lo(b[2 * n + 1]), v[3] * bf_hi(b[2 * n + 1])); }
                    stg<u32x4>(MG, ro + 256 * bj, w); }
                asm volatile("" ::: "memory"); }
    }
};
struct EpiOut {
    static constexpr bool HAS_MID = false;
    const float* x; float* out; float* oss;
    __device__ __forceinline__ void operator()(const f32x4 (&acc)[2][2][4][2], const Unit& u, int wr, int wc, int fr_, int fq_) const {
        const int fr = launder(fr_), fq = launder(fq_);
        const int row0 = u.pm * 256 + wr * 64 + fr;
        const unsigned ob = (unsigned)row0 * (D * 4) + (unsigned)(u.pn * 256 + 32 * wc + 4 * fq) * 4, sb = (unsigned)row0 * 64 + (unsigned)(u.pn * 4 + wc) * 4;
#pragma unroll
        for (int ai = 0; ai < 2; ++ai)
#pragma unroll
            for (int m = 0; m < 4; ++m) { const unsigned ro = ob + (unsigned)(ai * 128 + m * 16) * (D * 4); float ss = 0.f;
#pragma unroll
                for (int bj = 0; bj < 2; ++bj)
#pragma unroll
                    for (int n = 0; n < 2; ++n) { const f32x4 xv = ldg<f32x4>(x, ro + 512 * bj + 64 * n); const f32x4 o = xv + acc[ai][bj][m][n];
                        stg<f32x4>(out, ro + 512 * bj + 64 * n, o); ss += (o[0] * o[0] + o[1] * o[1]) + (o[2] * o[2] + o[3] * o[3]); }
                ss += __shfl_xor(ss, 16); ss += __shfl_xor(ss, 32); if (fq == 0) stg<float>(oss, sb + (ai * 128 + m * 16) * 64, ss);
                asm volatile("" ::: "memory"); }
    }
    __device__ __forceinline__ void mid(f32x4 (&)[2][2][4][2], const Unit&, int, int, int, int) const {}
};

__device__ __forceinline__ float wave_sum(float v) {
#pragma unroll
    for (int o = 1; o < 64; o <<= 1) v += __shfl_xor(v, o);
    return v;
}
__device__ __forceinline__ void tr_item(const float* W, int ldw, int srccol0, int k0, const float* kscale, bf16_t* dst, int ldd, int dstrow0, int dstcol0, bool perm, LAS float* scr, int lane) {
#pragma unroll 8
    for (int i = 0; i < 32; ++i) { const int kk = 2 * i + (lane >> 5); float v = W[(size_t)(k0 + kk) * ldw + srccol0 + (lane & 31)]; if (kscale) v *= kscale[k0 + kk]; scr[kk * 33 + (lane & 31)] = v; }
    asm volatile("s_waitcnt lgkmcnt(0)" ::: "memory");
    const int c = lane & 7;
#pragma unroll
    for (int j = 0; j < 4; ++j) { const int n = (lane >> 3) + 8 * j; const int sc = perm ? pg8::perm32(n) : n; const LAS float* s = scr + (8 * c) * 33 + sc;
        u32x4 o; o.x = cvt_pk_bf16(s[0 * 33], s[1 * 33]); o.y = cvt_pk_bf16(s[2 * 33], s[3 * 33]); o.z = cvt_pk_bf16(s[4 * 33], s[5 * 33]); o.w = cvt_pk_bf16(s[6 * 33], s[7 * 33]);
        *(u32x4*)(dst + (size_t)(dstrow0 + n) * ldd + dstcol0 + 8 * c) = o; }
    asm volatile("s_waitcnt lgkmcnt(0)" ::: "memory");
}
__device__ __forceinline__ int w1_src_col(int q) {
    const int tile = q >> 3, bj = (q >> 2) & 1, wc = q & 3;
    if (tile < 24) { const int type = tile >> 3, trel = tile & 7;
        const int seg = type == 0 ? (bj ? 2 : 0) : (type == 1 ? (bj ? 4 : 3) : (bj ? 6 : 5));
        return seg * D + 128 * trel + 32 * wc; }
    const int s = (tile - 24) >> 2, trel = (tile - 24) & 3; const int seg = s == 0 ? 1 : (s == 1 ? 7 : 8);
    return seg * D + 256 * trel + 128 * bj + 32 * wc;
}

struct Args { const float* in[11]; float* out; unsigned char* ws; int ph_lo, ph_hi; };

__global__ void __launch_bounds__(512, 2) mk_fwd(Args args) {
    extern __shared__ __attribute__((aligned(16))) unsigned char shm[];
    cg::grid_group grid = cg::this_grid();
    LAS unsigned char* lds = (LAS unsigned char*)shm;
    const int wave = __builtin_amdgcn_readfirstlane(threadIdx.x >> 6);
    const int G = gridDim.x, gw = blockIdx.x * 8 + wave, NGW = G * 8;
    unsigned char* ws = args.ws;
    const float* x = args.in[0]; const float* norm_g = args.in[1]; const float* w_in = args.in[2]; const float* v_norm_g = args.in[3];
    const float* w_sp = args.in[4]; const float* b_sp = args.in[5]; const float* conv_w = args.in[6];
    const float* w_pa = args.in[7]; const float* w_pb = args.in[8]; const float* w_out = args.in[9]; const float* fin_g = args.in[10];
    float* out = args.out;
    bf16_t* W1T = (bf16_t*)(ws + WS_W1T); bf16_t* B2T = (bf16_t*)(ws + WS_B2T); bf16_t* WOT = (bf16_t*)(ws + WS_WOT); bf16_t* WSB = (bf16_t*)(ws + WS_WSB);
    float* RINV = (float*)(ws + WS_RINV); float* VSS = (float*)(ws + WS_VSS); float* OSS = (float*)(ws + WS_OSS);
    bf16_t* XB = (bf16_t*)(ws + WS_XB); bf16_t* MG = XB; bf16_t* UZ = (bf16_t*)(ws + WS_UZ); bf16_t* BZ = (bf16_t*)(ws + WS_BZ);
    bf16_t* GV = (bf16_t*)(ws + WS_GV); bf16_t* HC = (bf16_t*)(ws + WS_HC); bf16_t* SA = (bf16_t*)(ws + WS_SA); bf16_t* SB = (bf16_t*)(ws + WS_SB);
    const int lo = args.ph_lo, hi = args.ph_hi;
#define IN(k) (lo <= (k) && (k) < hi)
#define BOTH(k) (IN(k) && IN((k) + 1))

    if (IN(0)) {
        const int lane = pg8::lane_id(), tid = wave * 64 + lane;
        LAS float* scr = (LAS float*)(lds + wave * 16384);
        constexpr int I_W1 = 288 * 16, I_B2 = 2 * 32 * 16, I_WO = 32 * 16, NITEMS = I_W1 + I_B2 + I_WO;
        for (int it = gw; it < NITEMS; it += NGW) {
            int r = it;
            if (r < I_W1) { const int q = r >> 4, kb = r & 15; tr_item(w_in, NPROJ, w1_src_col(q), 64 * kb, norm_g, W1T, D, 32 * q, 64 * kb, true, scr, lane); continue; } r -= I_W1;
            if (r < I_B2) { const int src = r >> 9, q = (r >> 4) & 31, kb = r & 15; tr_item(src ? w_pb : w_pa, D, 32 * q, 64 * kb, nullptr, B2T, 2 * D, 32 * q, src * D + 64 * kb, true, scr, lane); continue; } r -= I_B2;
            { const int q = r >> 4, kb = r & 15; tr_item(w_out, D, 32 * q, 64 * kb, nullptr, WOT, D, 32 * q, 64 * kb, false, scr, lane); }
        }
        for (int i = blockIdx.x * 512 + tid; i < NGRP * SCH * SCH; i += G * 512) { const int t = (i >> 7) & 127, s = i & 127; const float v = s <= t ? w_sp[i] : 0.f; WSB[i] = (bf16_t)(cvt_pk_bf16(v, 0.f) & 0xffffu); }
        for (int m = gw; m < M; m += NGW) {
            const f32x4* xr = (const f32x4*)(x + (size_t)m * D) + lane; f32x4 v[4]; float s = 0.f;
#pragma unroll
            for (int j = 0; j < 4; ++j) { v[j] = xr[64 * j]; s += (v[j].x * v[j].x + v[j].y * v[j].y) + (v[j].z * v[j].z + v[j].w * v[j].w); }
            s = wave_sum(s); if (lane == 0) RINV[m] = 1.0f / sqrtf(s * (1.0f / D) + EPS);
            u32x2* o8 = (u32x2*)(XB + (size_t)m * D) + lane;
#pragma unroll
            for (int j = 0; j < 4; ++j) o8[64 * j] = (u32x2){cvt_pk_bf16(v[j].x, v[j].y), cvt_pk_bf16(v[j].z, v[j].w)};
        }
        if (BOTH(0)) grid.sync();
    }

    if (IN(1)) {
        pg8::Gemm g{XB, W1T, M, NPROJ, D, D, D, 1 << 30, 0}; pg8::StaticOrder S; S.init(M, NPROJ, G, (int)blockIdx.x);
        EpiProj E{RINV, UZ, GV, HC, BZ, SA, SB, VSS};
        pg8::gemm_phase<EpiProj, pg8::StaticOrder>(lds, wave, g, S, E);
        if (BOTH(1)) grid.sync();
    }

    if (IN(2)) {
        constexpr int VP = 288;
        LAS unsigned char* vs = lds; LAS float* rvs = (LAS float*)(lds + 128 * VP);
        const int lane = pg8::lane_id(), tid = wave * 64 + lane;
        const int fr = lane & 15, fq = lane >> 4, cc = tid & 15, sr = tid >> 4;
        typedef short v4i16_t __attribute__((ext_vector_type(4)));
        for (int item = blockIdx.x; item < (M / SCH) * NGRP; item += G) {
            const int chunk = item >> 3, grp = item & 7, row0 = chunk * SCH, chb = grp * GDIM;
            if (tid < 128) { const f32x4* p = (const f32x4*)(VSS + (size_t)(row0 + tid) * 16); const f32x4 a = p[0], b = p[1], c = p[2], d = p[3];
                const float s = ((a.x + a.y) + (a.z + a.w)) + ((b.x + b.y) + (b.z + b.w)) + ((c.x + c.y) + (c.z + c.w)) + ((d.x + d.y) + (d.z + d.w));
                rvs[tid] = 1.0f / sqrtf(s * (1.0f / D) + EPS); }
            __syncthreads();
            { const f32x4 g0 = *(const f32x4*)(v_norm_g + chb + 8 * cc), g1 = *(const f32x4*)(v_norm_g + chb + 8 * cc + 4);
#pragma unroll
              for (int i = 0; i < 4; ++i) { const int s = sr + 32 * i; const u32x4 w = *(const u32x4*)(GV + (size_t)(row0 + s) * D + chb + 8 * cc); const float rv = rvs[s];
                  u32x4 o; o.x = cvt_pk_bf16(bf_lo(w.x) * rv * g0.x, bf_hi(w.x) * rv * g0.y); o.y = cvt_pk_bf16(bf_lo(w.y) * rv * g0.z, bf_hi(w.y) * rv * g0.w);
                  o.z = cvt_pk_bf16(bf_lo(w.z) * rv * g1.x, bf_hi(w.z) * rv * g1.y); o.w = cvt_pk_bf16(bf_lo(w.w) * rv * g1.z, bf_hi(w.w) * rv * g1.w);
                  *(LAS u32x4*)(vs + s * VP + cc * 16) = o; } }
            __syncthreads();
            f32x4 acc[8];
#pragma unroll
            for (int cb = 0; cb < 8; ++cb) acc[cb] = (f32x4){0.f, 0.f, 0.f, 0.f};
            const int nks = (wave >> 1) + 1;
            const bf16_t* wrow = WSB + ((size_t)(grp * SCH + 16 * wave + fr) * SCH + 8 * fq);
            const LAS unsigned char* vb = vs + (8 * fq + (fr >> 2)) * VP + (fr & 3) * 8;
#pragma unroll
            for (int ks = 0; ks < 4; ++ks) if (ks < nks) {
                const bf16x8 af = *(const bf16x8*)(wrow + 32 * ks);
#pragma unroll
                for (int cb = 0; cb < 8; ++cb) {
                    const v4i16_t l0 = __builtin_amdgcn_ds_read_tr16_b64_v4i16((LAS v4i16_t*)(vb + (32 * ks) * VP + cb * 32));
                    const v4i16_t l1 = __builtin_amdgcn_ds_read_tr16_b64_v4i16((LAS v4i16_t*)(vb + (32 * ks + 4) * VP + cb * 32));
                    const bf16x8 bfr = __builtin_shufflevector(l0, l1, 0, 1, 2, 3, 4, 5, 6, 7);
                    acc[cb] = __builtin_amdgcn_mfma_f32_16x16x32_bf16(bfr, af, acc[cb], 0, 0, 0);
                }
            }
            { const int t = 16 * wave + fr; const float bias = b_sp[grp * SCH + t]; bf16_t* p = UZ + (size_t)(row0 + t) * D + chb + 4 * fq;
#pragma unroll
              for (int cb = 0; cb < 8; ++cb) { const u32x2 uz = *(const u32x2*)(p + 16 * cb); const f32x4 mx = acc[cb] + bias;
                  *(u32x2*)(p + 16 * cb) = (u32x2){cvt_pk_bf16(bf_lo(uz.x) * mx[0], bf_hi(uz.x) * mx[1]), cvt_pk_bf16(bf_lo(uz.y) * mx[2], bf_hi(uz.y) * mx[3])}; } }
            { const int ch = chb + 8 * cc;
              const f32x4 w0a = *(const f32x4*)(conv_w + ch), w0b = *(const f32x4*)(conv_w + ch + 4), w1a = *(const f32x4*)(conv_w + D + ch), w1b = *(const f32x4*)(conv_w + D + ch + 4),
                          w2a = *(const f32x4*)(conv_w + 2 * D + ch), w2b = *(const f32x4*)(conv_w + 2 * D + ch + 4);
#pragma unroll
              for (int i = 0; i < 4; ++i) { const int row = row0 + sr + 32 * i, tseq = row & (SEQ - 1); const size_t off = (size_t)row * D + ch;
                  const u32x4 z4 = (u32x4){0u, 0u, 0u, 0u};
                  const u32x4 h0 = *(const u32x4*)(HC + off), h1 = tseq >= 1 ? *(const u32x4*)(HC + off - D) : z4, h2 = tseq >= 2 ? *(const u32x4*)(HC + off - 2 * D) : z4, bz = *(const u32x4*)(BZ + off);
                  u32x4 o;
                  o.x = cvt_pk_bf16(bf_lo(bz.x) * (w0a.x * bf_lo(h2.x) + w1a.x * bf_lo(h1.x) + w2a.x * bf_lo(h0.x)), bf_hi(bz.x) * (w0a.y * bf_hi(h2.x) + w1a.y * bf_hi(h1.x) + w2a.y * bf_hi(h0.x)));
                  o.y = cvt_pk_bf16(bf_lo(bz.y) * (w0a.z * bf_lo(h2.y) + w1a.z * bf_lo(h1.y) + w2a.z * bf_lo(h0.y)), bf_hi(bz.y) * (w0a.w * bf_hi(h2.y) + w1a.w * bf_hi(h1.y) + w2a.w * bf_hi(h0.y)));
                  o.z = cvt_pk_bf16(bf_lo(bz.z) * (w0b.x * bf_lo(h2.z) + w1b.x * bf_lo(h1.z) + w2b.x * bf_lo(h0.z)), bf_hi(bz.z) * (w0b.y * bf_hi(h2.z) + w1b.y * bf_hi(h1.z) + w2b.y * bf_hi(h0.z)));
                  o.w = cvt_pk_bf16(bf_lo(bz.w) * (w0b.z * bf_lo(h2.w) + w1b.z * bf_lo(h1.w) + w2b.z * bf_lo(h0.w)), bf_hi(bz.w) * (w0b.w * bf_hi(h2.w) + w1b.w * bf_hi(h1.w) + w2b.w * bf_hi(h0.w)));
                  *(u32x4*)(BZ + off) = o; } }
            __syncthreads();
        }
        if (BOTH(2)) grid.sync();
    }

    if (IN(3)) {
        pg8::Gemm g{UZ, B2T, M, D, 2 * D, D, 2 * D, 16, (long)(WS_BZ - WS_UZ) - 2 * D}; pg8::StaticOrder S; S.init(M, D, G, (int)blockIdx.x);
        EpiMerge E{SA, SB, MG};
        pg8::gemm_phase<EpiMerge, pg8::StaticOrder>(lds, wave, g, S, E);
        if (BOTH(3)) grid.sync();
    }

    if (IN(4)) {
        pg8::Gemm g{MG, WOT, M, D, D, D, D, 1 << 30, 0}; pg8::StaticOrder S; S.init(M, D, G, (int)blockIdx.x);
        EpiOut E{x, out, OSS};
        pg8::gemm_phase<EpiOut, pg8::StaticOrder>(lds, wave, g, S, E);
        if (BOTH(4)) grid.sync();
    }

    if (IN(5)) {
        const int lane = pg8::lane_id();
        for (int m = gw; m < M; m += NGW) {
            float s = OSS[(size_t)m * 16 + (lane & 15)];
            s += __shfl_xor(s, 1); s += __shfl_xor(s, 2); s += __shfl_xor(s, 4); s += __shfl_xor(s, 8);
            const float rr = 1.0f / sqrtf(s * (1.0f / D) + EPS);
            f32x4* orow = (f32x4*)(out + (size_t)m * D) + lane; const f32x4* gp = (const f32x4*)fin_g + lane;
#pragma unroll
            for (int j = 0; j < 4; ++j) { const f32x4 v = orow[64 * j]; orow[64 * j] = v * rr * gp[64 * j]; }
        }
    }
#undef IN
#undef BOTH
}

extern "C" void kernel_launch(void* const* d_in, const int* in_sizes, int n_in, void* d_out, int out_size, void* d_ws, size_t ws_size, hipStream_t stream) {
    static int grid = 0;
    if (grid == 0) {
        if (n_in != 11 || in_sizes[0] != M * D || out_size != M * D || ws_size < WS_END) { fprintf(stderr, "kernel_launch: unexpected shapes (n_in %d, in0 %d, out %d, ws %zu); nothing launched\n", n_in, n_in > 0 ? in_sizes[0] : -1, out_size, ws_size); grid = -1; return; }
        int dev = 0, cus = 0, per_cu = 0;
        if (hipGetDevice(&dev) != hipSuccess || hipDeviceGetAttribute(&cus, hipDeviceAttributeMultiprocessorCount, dev) != hipSuccess) { grid = -1; return; }
        if (hipFuncSetAttribute((const void*)mk_fwd, hipFuncAttributeMaxDynamicSharedMemorySize, LDS_BYTES) != hipSuccess) { fprintf(stderr, "kernel_launch: hipFuncSetAttribute failed\n"); grid = -1; return; }
        if (hipOccupancyMaxActiveBlocksPerMultiprocessor(&per_cu, (const void*)mk_fwd, 512, LDS_BYTES) != hipSuccess || per_cu < 1) { fprintf(stderr, "kernel_launch: occupancy query says %d\n", per_cu); per_cu = 1; }
        (void)hipGetLastError();
        grid = cus * 1;
    }
    if (grid < 0) return;
    Args a{};
    for (int i = 0; i < 11; ++i) a.in[i] = (const float*)d_in[i];
    a.out = (float*)d_out; a.ws = (unsigned char*)d_ws;
#if MK_N_LAUNCHES == 1
    a.ph_lo = 0; a.ph_hi = 6;
    void* kargs[] = {&a};
    hipError_t e = hipLaunchCooperativeKernel((const void*)mk_fwd, dim3(grid), dim3(512), kargs, LDS_BYTES, stream);
    if (e != hipSuccess) fprintf(stderr, "kernel_launch: cooperative launch failed: %s (grid %d)\n", hipGetErrorString(e), grid);
#else
    for (int p = 0; p < 6; ++p) { a.ph_lo = p; a.ph_hi = p + 1; hipLaunchKernelGGL(mk_fwd, dim3(grid), dim3(512), LDS_BYTES, stream, a); }
#endif
}
```

```cpp
#include <hip/hip_runtime.h>
#include <hip/hip_cooperative_groups.h>
#include <cstdio>
#include <cstdint>
namespace cg = cooperative_groups;

#ifndef MK_N_LAUNCHES
#define MK_N_LAUNCHES 1
#endif

namespace pg8 {
#define PG8_LAS __attribute__((address_space(3)))
typedef unsigned short bf16_t;
typedef short bf16x8 __attribute__((ext_vector_type(8)));
typedef float f32x4 __attribute__((ext_vector_type(4)));
typedef float f32x2 __attribute__((ext_vector_type(2)));
typedef unsigned u32x4 __attribute__((ext_vector_type(4)));
typedef unsigned u32x2 __attribute__((ext_vector_type(2)));
constexpr int BM = 256, BK = 64, HALF = 128, HTB = HALF * BK * 2, STAGE_BYTES = 8 * HTB, NXCD = 8, WGM = 8;

__host__ __device__ __forceinline__ int lds_byte(int r, int c) { const int st = (r >> 4) * 2 + (c >> 5), rr = r & 15, cc = c & 31, ob = rr * 64 + cc * 2; return st * 1024 + (ob ^ (((ob >> 9) & 1) << 5)); }
__host__ __device__ __forceinline__ void stage_rc(int b, int& R, int& C) { const int st = b / 1024, sb = b % 1024, swz = sb ^ (((sb >> 9) & 1) << 5); R = (st >> 1) * 16 + swz / 64; C = (st & 1) * 32 + (swz % 64) / 2; }
__host__ __device__ __forceinline__ int perm32(int rho) { const int n = rho >> 4, i = rho & 15; return 8 * (i >> 2) + 4 * n + (i & 3); }

struct Unit { int pm, pn; };
struct Gemm { const bf16_t* A; const bf16_t* Bt; int M, N, K, lda, ldb, ksplit; long asplit; };

struct StaticOrder {
    int nM, nN, nwg, G, c;
    __host__ __device__ void init(int M, int N, int G_, int c_) { nM = M / BM; nN = N / BM; nwg = nM * nN; G = G_; c = c_; }
    __host__ __device__ bool next(int i, Unit& u) const {
        const long L = (long)i * G + c; if (L >= nwg) return false;
        int wgid = (int)L; { const int q = nwg / NXCD, r = nwg % NXCD, xcd = wgid % NXCD, off = wgid / NXCD; wgid = (xcd < r ? xcd * (q + 1) : r * (q + 1) + (xcd - r) * q) + off; }
        const int nig = WGM * nN, gid = wgid / nig, fm = gid * WGM, gsz = (nM - fm) < WGM ? (nM - fm) : WGM;
        u.pm = fm + ((wgid % nig) % gsz); u.pn = (wgid % nig) / gsz; return true;
    }
};

__device__ __forceinline__ unsigned cvt_pk_bf16(float lo, float hi) { unsigned r; asm volatile("v_cvt_pk_bf16_f32 %0, %1, %2" : "=v"(r) : "v"(lo), "v"(hi)); return r; }
__device__ __forceinline__ float bf_lo(unsigned w) { return __builtin_bit_cast(float, w << 16); }
__device__ __forceinline__ float bf_hi(unsigned w) { return __builtin_bit_cast(float, w & 0xffff0000u); }
__device__ __forceinline__ f32x2 gelu_pk(f32x2 v) {
    const f32x2 av = __builtin_elementwise_abs(v), d = av * 0.2316418882f + 1.0f;
    f32x2 t; t.x = __builtin_amdgcn_rcpf(d.x); t.y = __builtin_amdgcn_rcpf(d.y);
    f32x2 q = t * 0.5307027145f + (-0.7265760135f); q = q * t + 0.7107068705f; q = q * t + (-0.142248368f); q = q * t + 0.127414796f; q = q * t;
    const f32x2 s = (v * v) * (-0.72134752044f);
    f32x2 e; e.x = __builtin_amdgcn_exp2f(s.x); e.y = __builtin_amdgcn_exp2f(s.y);
    const f32x2 m = v * (q * e), r = v - m;
    f32x2 o; o.x = v.x < 0.f ? m.x : r.x; o.y = v.y < 0.f ? m.y : r.y; return o;
}
__device__ __forceinline__ float sigmoid_f(float z) { return __builtin_amdgcn_rcpf(1.0f + __builtin_amdgcn_exp2f(z * -1.44269504089f)); }
__device__ __forceinline__ float silu_f(float z) { return z * sigmoid_f(z); }
template <class T> __device__ __forceinline__ T ldg(const void* base, unsigned off) { return *(const T*)((const char*)base + off); }
template <class T> __device__ __forceinline__ void stg(void* base, unsigned off, T v) { *(T*)((char*)base + off) = v; }
__device__ __forceinline__ int launder(int v) { asm volatile("" : "+v"(v)); return v; }
__device__ __forceinline__ int lane_id() { int l; asm volatile("v_mbcnt_lo_u32_b32 %0, -1, 0\n\tv_mbcnt_hi_u32_b32 %0, -1, %0" : "=v"(l)); return l; }

template <class Epi, class Sched, bool ALIGN_EPI = true, bool SP2 = true>
__device__ __forceinline__ void gemm_phase(PG8_LAS unsigned char* lds, const int wid, const Gemm g, const Sched& S, const Epi& E) {
    const int lane = lane_id(), tid = wid * 64 + lane, wr = wid >> 2, wc = wid & 3, fr = lane & 15, fq = lane >> 4;
    const int nt = g.K / BK;
    unsigned voffA[2], voffB[2];
#pragma unroll
    for (int i = 0; i < 2; ++i) { int R, C; stage_rc(tid * 16 + i * 8192, R, C);
        voffA[i] = (unsigned)(R * g.lda + C) * 2u; voffB[i] = (unsigned)(R * g.ldb + C) * 2u; }
    const size_t kstep = (size_t)(BK * 2);
    const size_t hstepA = (size_t)HALF * g.lda * 2, hstepB = (size_t)HALF * g.ldb * 2;
    const size_t tstepA = 2 * hstepA, tstepB = 2 * hstepB;
    const unsigned ldsw = (unsigned)wid * 1024u;
    const int aoff = lds_byte(wr * 64 + fr, fq * 8), boff = lds_byte(wc * 32 + fr, fq * 8);
    const int ksplit = g.ksplit; const long asplit = g.asplit;
#define PG8_AP(base, tt) ((base) + (size_t)(tt) * kstep + ((tt) >= ksplit ? asplit : 0l))
#define PG8_SA(b, h) (((b) * 2 + (h)) * HTB)
#define PG8_SB(b, h) ((4 + (b) * 2 + (h)) * HTB)
#define PG8_STAGE(bufoff, gbase, voff) do { _Pragma("unroll") for (int _i = 0; _i < 2; ++_i) \
        __builtin_amdgcn_global_load_lds((const unsigned*)((const char*)(gbase) + (voff)[_i]), (PG8_LAS unsigned*)(lds + (bufoff) + ldsw + _i * 8192), 16, 0, 0); } while (0)
#define PG8_LDA(dst, b, h) do { _Pragma("unroll") for (int m = 0; m < 4; ++m) _Pragma("unroll") for (int k = 0; k < 2; ++k) dst[m][k] = *(const PG8_LAS bf16x8*)(lds + PG8_SA(b, h) + aoff + m * 2048 + k * 1024); } while (0)
#define PG8_LDB(dst, b, h) do { _Pragma("unroll") for (int n = 0; n < 2; ++n) _Pragma("unroll") for (int k = 0; k < 2; ++k) dst[n][k] = *(const PG8_LAS bf16x8*)(lds + PG8_SB(b, h) + boff + n * 2048 + k * 1024); } while (0)
#define PG8_MMA(ai, bj, At, Bt) do { __builtin_amdgcn_s_setprio(1); _Pragma("unroll") for (int m = 0; m < 4; ++m) _Pragma("unroll") for (int n = 0; n < 2; ++n) _Pragma("unroll") for (int k = 0; k < 2; ++k) \
        acc[ai][bj][m][n] = __builtin_amdgcn_mfma_f32_16x16x32_bf16(Bt[n][k], At[m][k], acc[ai][bj][m][n], 0, 0, 0); __builtin_amdgcn_s_setprio(0); } while (0)
#define PG8_WAIT_V(n) asm volatile("s_waitcnt vmcnt(" #n ")" ::: "memory")
#define PG8_WAIT_L(n) asm volatile("s_waitcnt lgkmcnt(" #n ")" ::: "memory")
#define PG8_BAR __builtin_amdgcn_s_barrier()
#define PG8_SCHED __builtin_amdgcn_sched_barrier(0)
    Unit cur, nxt; int ui = 0;
    if (!S.next(0, cur)) return;
    f32x4 acc[2][2][4][2];
#pragma unroll
    for (int a = 0; a < 2; ++a)
#pragma unroll
        for (int b = 0; b < 2; ++b)
#pragma unroll
            for (int m = 0; m < 4; ++m)
#pragma unroll
                for (int n = 0; n < 2; ++n) acc[a][b][m][n] = (f32x4){0.f, 0.f, 0.f, 0.f};
    bf16x8 At[4][2], B0[2][2], B1[2][2];
    const char* cA = (const char*)g.A + (size_t)cur.pm * tstepA; const char* cB = (const char*)g.Bt + (size_t)cur.pn * tstepB;
    if constexpr (SP2) {
        PG8_STAGE(PG8_SB(0, 0), cB, voffB); PG8_STAGE(PG8_SB(0, 1), cB + hstepB, voffB); PG8_STAGE(PG8_SA(0, 0), cA, voffA); PG8_STAGE(PG8_SA(0, 1), cA + hstepA, voffA);
        if (wr == 1) PG8_BAR;
        PG8_WAIT_V(2); PG8_BAR;
        PG8_STAGE(PG8_SB(1, 0), cB + kstep, voffB); PG8_STAGE(PG8_SA(1, 0), cA + kstep, voffA); PG8_STAGE(PG8_SB(1, 1), cB + hstepB + kstep, voffB);
        PG8_WAIT_V(6); PG8_BAR;
    } else {
        PG8_STAGE(PG8_SB(0, 0), cB, voffB); PG8_STAGE(PG8_SA(0, 0), cA, voffA); PG8_STAGE(PG8_SB(0, 1), cB + hstepB, voffB); PG8_STAGE(PG8_SA(0, 1), cA + hstepA, voffA);
        if (wr == 1) PG8_BAR;
        PG8_WAIT_V(4); PG8_BAR;
        PG8_STAGE(PG8_SB(1, 0), cB + kstep, voffB); PG8_STAGE(PG8_SA(1, 0), cA + kstep, voffA); PG8_STAGE(PG8_SB(1, 1), cB + hstepB + kstep, voffB);
        PG8_WAIT_V(6); PG8_BAR;
    }
    for (;;) {
        const bool has_next = S.next(ui + 1, nxt);
        const char* nA = has_next ? (const char*)g.A + (size_t)nxt.pm * tstepA : cA; const char* nB = has_next ? (const char*)g.Bt + (size_t)nxt.pn * tstepB : cB;
        for (int t = 0; t < nt; t += 2) {
            const bool last = (t == nt - 2);
            if constexpr (Epi::HAS_MID) { if (t == ksplit) E.mid(acc, cur, wr, wc, fr, fq); }
            const char* a1 = PG8_AP(cA, t + 1);
            const char* a2 = last ? nA : PG8_AP(cA, t + 2); const char* b2 = last ? nB : cB + (size_t)(t + 2) * kstep;
            const char* a3 = last ? nA + kstep : PG8_AP(cA, t + 3); const char* b3 = b2 + kstep;
            if constexpr (SP2) {
            PG8_LDB(B0, 0, 0); PG8_LDB(B1, 0, 1); PG8_SCHED; PG8_LDA(At, 0, 0); PG8_STAGE(PG8_SA(1, 1), a1 + hstepA, voffA);
            PG8_WAIT_V(8); PG8_WAIT_L(0); PG8_BAR; PG8_MMA(0, 0, At, B0); PG8_MMA(0, 1, At, B1); PG8_BAR; PG8_SCHED;
            PG8_LDA(At, 0, 1); PG8_STAGE(PG8_SB(0, 0), b2, voffB); PG8_STAGE(PG8_SB(0, 1), b2 + hstepB, voffB); PG8_STAGE(PG8_SA(0, 0), a2, voffA);
            PG8_WAIT_V(8); PG8_WAIT_L(0); PG8_BAR; PG8_MMA(1, 0, At, B0); PG8_MMA(1, 1, At, B1); PG8_BAR; PG8_SCHED;
            PG8_LDB(B0, 1, 0); PG8_LDB(B1, 1, 1); PG8_SCHED; PG8_LDA(At, 1, 0); PG8_STAGE(PG8_SA(0, 1), a2 + hstepA, voffA);
            PG8_WAIT_V(8); PG8_WAIT_L(0); PG8_BAR; PG8_MMA(0, 0, At, B0); PG8_MMA(0, 1, At, B1); PG8_BAR; PG8_SCHED;
            PG8_LDA(At, 1, 1); PG8_STAGE(PG8_SB(1, 0), b3, voffB); PG8_STAGE(PG8_SB(1, 1), b3 + hstepB, voffB); PG8_STAGE(PG8_SA(1, 0), a3, voffA);
            PG8_WAIT_V(8); PG8_WAIT_L(0); PG8_BAR; PG8_MMA(1, 0, At, B0); PG8_MMA(1, 1, At, B1); PG8_BAR; PG8_SCHED;
            } else {
            PG8_LDB(B0, 0, 0); PG8_SCHED; PG8_LDA(At, 0, 0); PG8_STAGE(PG8_SA(1, 1), a1 + hstepA, voffA);
            PG8_WAIT_L(8); PG8_BAR; PG8_WAIT_L(0); PG8_MMA(0, 0, At, B0); PG8_BAR; PG8_SCHED;
            PG8_LDB(B1, 0, 1); PG8_STAGE(PG8_SB(0, 0), b2, voffB);
            PG8_BAR; PG8_WAIT_L(0); PG8_MMA(0, 1, At, B1); PG8_BAR;
            PG8_LDA(At, 0, 1); PG8_STAGE(PG8_SA(0, 0), a2, voffA);
            PG8_BAR; PG8_WAIT_L(0); PG8_MMA(1, 0, At, B0); PG8_BAR; PG8_SCHED;
            PG8_STAGE(PG8_SB(0, 1), b2 + hstepB, voffB);
            PG8_WAIT_V(6); PG8_BAR; PG8_MMA(1, 1, At, B1); PG8_BAR;
            PG8_LDB(B0, 1, 0); PG8_SCHED; PG8_LDA(At, 1, 0); PG8_STAGE(PG8_SA(0, 1), a2 + hstepA, voffA);
            PG8_WAIT_L(8); PG8_BAR; PG8_WAIT_L(0); PG8_MMA(0, 0, At, B0); PG8_BAR; PG8_SCHED;
            PG8_LDB(B1, 1, 1); PG8_STAGE(PG8_SB(1, 0), b3, voffB);
            PG8_BAR; PG8_WAIT_L(0); PG8_MMA(0, 1, At, B1); PG8_BAR;
            PG8_LDA(At, 1, 1); PG8_STAGE(PG8_SA(1, 0), a3, voffA);
            PG8_BAR; PG8_WAIT_L(0); PG8_MMA(1, 0, At, B0); PG8_BAR; PG8_SCHED;
            PG8_STAGE(PG8_SB(1, 1), b3 + hstepB, voffB);
            PG8_WAIT_V(6); PG8_BAR; PG8_MMA(1, 1, At, B1); PG8_BAR;
            }
        }
        if constexpr (ALIGN_EPI) { if (wr == 0) PG8_BAR; }
        E(acc, cur, wr, wc, fr, fq);
        if (!has_next) break;
#pragma unroll
        for (int a = 0; a < 2; ++a)
#pragma unroll
            for (int b = 0; b < 2; ++b)
#pragma unroll
                for (int m = 0; m < 4; ++m)
#pragma unroll
                    for (int n = 0; n < 2; ++n) acc[a][b][m][n] = (f32x4){0.f, 0.f, 0.f, 0.f};
        cur = nxt; cA = nA; cB = nB; ++ui;
        if constexpr (ALIGN_EPI) { if (wr == 1) PG8_BAR; }
    }
    PG8_WAIT_V(0);
    if constexpr (!ALIGN_EPI) { if (wr == 0) PG8_BAR; }
    PG8_BAR;
#undef PG8_AP
#undef PG8_SA
#undef PG8_SB
#undef PG8_STAGE
#undef PG8_LDA
#undef PG8_LDB
#undef PG8_MMA
#undef PG8_WAIT_V
#undef PG8_WAIT_L
#undef PG8_BAR
#undef PG8_SCHED
}
}

using pg8::bf16_t; using pg8::bf16x8; using pg8::f32x4; using pg8::f32x2; using pg8::u32x4; using pg8::u32x2; using pg8::Unit;
using pg8::cvt_pk_bf16; using pg8::bf_lo; using pg8::bf_hi; using pg8::gelu_pk; using pg8::sigmoid_f; using pg8::silu_f;
#define LAS __attribute__((address_space(3)))

constexpr int BATCH = 4, SEQ = 8192, D = 1024, M = BATCH * SEQ, NPROJ = 9 * D, NGRP = 8, GDIM = 128, SCH = 128;
constexpr float EPS = 1e-6f;
constexpr size_t MiB = 1u << 20;
constexpr size_t WS_W1T = 1 * MiB;
constexpr size_t WS_B2T = 19 * MiB;
constexpr size_t WS_WOT = 23 * MiB;
constexpr size_t WS_WSB = 25 * MiB;
constexpr size_t WS_RINV = 26 * MiB;
constexpr size_t WS_VSS = 27 * MiB;
constexpr size_t WS_OSS = 29 * MiB;
constexpr size_t WS_XB = 32 * MiB;
constexpr size_t WS_UZ = 96 * MiB;
constexpr size_t WS_BZ = 160 * MiB;
constexpr size_t WS_GV = 224 * MiB;
constexpr size_t WS_HC = 288 * MiB;
constexpr size_t WS_SA = 352 * MiB;
constexpr size_t WS_SB = 416 * MiB;
constexpr size_t WS_END = 480 * MiB;
constexpr int LDS_BYTES = 131072 + 512;

using pg8::ldg; using pg8::stg; using pg8::launder;
template <int TYPE>
__device__ __forceinline__ void pair_rows(const f32x4 (&acc)[2][2][4][2], bf16_t* O, const float* rinv, int row0, int ch) {
    const unsigned ob = (unsigned)row0 * (D * 2) + (unsigned)ch * 2, rb = (unsigned)row0 * 4;
#pragma unroll
    for (int ai = 0; ai < 2; ++ai)
#pragma unroll
        for (int m = 0; m < 4; ++m) {
            const float rr = ldg<float>(rinv, rb + (ai * 128 + m * 16) * 4);
            u32x4 w;
#pragma unroll
            for (int n = 0; n < 2; ++n) {
                const f32x4 a = acc[ai][0][m][n] * rr, b = acc[ai][1][m][n] * rr; f32x4 o;
                if (TYPE == 0) { const f32x2 g0 = gelu_pk((f32x2){a[0], a[1]}), g1 = gelu_pk((f32x2){a[2], a[3]});
                    o = (f32x4){g0.x * silu_f(b[0]), g0.y * silu_f(b[1]), g1.x * silu_f(b[2]), g1.y * silu_f(b[3])}; }
                else if (TYPE == 1) o = a * b;
                else o = (f32x4){a[0] * silu_f(b[0]), a[1] * silu_f(b[1]), a[2] * silu_f(b[2]), a[3] * silu_f(b[3])};
                w[2 * n] = cvt_pk_bf16(o[0], o[1]); w[2 * n + 1] = cvt_pk_bf16(o[2], o[3]);
            }
            stg<u32x4>(O, ob + (unsigned)(ai * 128 + m * 16) * (D * 2), w);
        }
}
template <int TYPE>
__device__ __forceinline__ void single_rows(const f32x4 (&acc)[2][2][4][2], bf16_t* O, const float* rinv, float* vss, int row0, int ch0, int slot, int fq) {
    const unsigned ob = (unsigned)row0 * (D * 2) + (unsigned)ch0 * 2, rb = (unsigned)row0 * 4, sb = (unsigned)row0 * 64 + (unsigned)slot * 4;
#pragma unroll
    for (int ai = 0; ai < 2; ++ai)
#pragma unroll
        for (int m = 0; m < 4; ++m) {
            const float rr = ldg<float>(rinv, rb + (ai * 128 + m * 16) * 4); float ss = 0.f;
#pragma unroll
            for (int bj = 0; bj < 2; ++bj) { u32x4 w;
#pragma unroll
                for (int n = 0; n < 2; ++n) {
                    const f32x4 v = acc[ai][bj][m][n] * rr; f32x4 o;
                    if (TYPE == 0) { const f32x2 g0 = gelu_pk((f32x2){v[0], v[1]}), g1 = gelu_pk((f32x2){v[2], v[3]}); o = (f32x4){g0.x, g0.y, g1.x, g1.y};
                        ss += (o[0] * o[0] + o[1] * o[1]) + (o[2] * o[2] + o[3] * o[3]); }
                    else o = (f32x4){sigmoid_f(v[0]), sigmoid_f(v[1]), sigmoid_f(v[2]), sigmoid_f(v[3])};
                    w[2 * n] = cvt_pk_bf16(o[0], o[1]); w[2 * n + 1] = cvt_pk_bf16(o[2], o[3]);
                }
                stg<u32x4>(O, ob + (unsigned)(ai * 128 + m * 16) * (D * 2) + 256 * bj, w); }
            if (TYPE == 0) { ss += __shfl_xor(ss, 16); ss += __shfl_xor(ss, 32); if (fq == 0) stg<float>(vss, sb + (ai * 128 + m * 16) * 64, ss); }
        }
}
struct EpiProj {
    static constexpr bool HAS_MID = false;
    const float* rinv; bf16_t *UZ, *GV, *HC, *BZ, *SA, *SB; float* vss;
    __device__ __forceinline__ void operator()(const f32x4 (&acc)[2][2][4][2], const Unit& u, int wr, int wc, int fr_, int fq_) const {
        const int fr = launder(fr_), fq = launder(fq_);
        const int pn = u.pn, row0 = u.pm * 256 + wr * 64 + fr;
        if (pn < 24) {
            const int type = pn >> 3, ch = 128 * (pn & 7) + 32 * wc + 8 * fq;
            if (type == 0) pair_rows<0>(acc, UZ, rinv, row0, ch);
            else if (type == 1) pair_rows<1>(acc, HC, rinv, row0, ch);
            else pair_rows<2>(acc, BZ, rinv, row0, ch);
        } else {
            const int s = (pn - 24) >> 2, trel = (pn - 24) & 3, ch0 = 256 * trel + 32 * wc + 8 * fq;
            if (s == 0) single_rows<0>(acc, GV, rinv, vss, row0, ch0, trel * 4 + wc, fq);
            else single_rows<1>(acc, s == 1 ? SA : SB, rinv, vss, row0, ch0, 0, fq);
        }
    }
    __device__ __forceinline__ void mid(f32x4 (&)[2][2][4][2], const Unit&, int, int, int, int) const {}
};
struct EpiMerge {
    static constexpr bool HAS_MID = true;
    const bf16_t *SA, *SB; bf16_t* MG;
    __device__ __forceinline__ void mid(f32x4 (&acc)[2][2][4][2], const Unit& u, int wr, int wc, int fr_, int fq_) const {
        const int fr = launder(fr_), fq = launder(fq_);
        const unsigned ob = (unsigned)(u.pm * 256 + wr * 64 + fr) * (D * 2) + (unsigned)(u.pn * 256 + 32 * wc + 8 * fq) * 2;
#pragma unroll
        for (int ai = 0; ai < 2; ++ai)
#pragma unroll
            for (int m = 0; m < 4; ++m) { const unsigned ro = ob + (unsigned)(ai * 128 + m * 16) * (D * 2);
#pragma unroll
                for (int bj = 0; bj < 2; ++bj) { const u32x4 a = ldg<u32x4>(SA, ro + 256 * bj), b = ldg<u32x4>(SB, ro + 256 * bj);
#pragma unroll
                    for (int n = 0; n < 2; ++n) { f32x4 q;
                        q[0] = bf_lo(a[2 * n]) * __builtin_amdgcn_rcpf(bf_lo(b[2 * n])); q[1] = bf_hi(a[2 * n]) * __builtin_amdgcn_rcpf(bf_hi(b[2 * n]));
                        q[2] = bf_lo(a[2 * n + 1]) * __builtin_amdgcn_rcpf(bf_lo(b[2 * n + 1])); q[3] = bf_hi(a[2 * n + 1]) * __builtin_amdgcn_rcpf(bf_hi(b[2 * n + 1]));
                        acc[ai][bj][m][n] *= q; } }
                asm volatile("" ::: "memory"); }
    }
    __device__ __forceinline__ void operator()(const f32x4 (&acc)[2][2][4][2], const Unit& u, int wr, int wc, int fr_, int fq_) const {
        const int fr = launder(fr_), fq = launder(fq_);
        const unsigned ob = (unsigned)(u.pm * 256 + wr * 64 + fr) * (D * 2) + (unsigned)(u.pn * 256 + 32 * wc + 8 * fq) * 2;
#pragma unroll
        for (int ai = 0; ai < 2; ++ai)
#pragma unroll
            for (int m = 0; m < 4; ++m) { const unsigned ro = ob + (unsigned)(ai * 128 + m * 16) * (D * 2);
#pragma unroll
                for (int bj = 0; bj < 2; ++bj) { const u32x4 b = ldg<u32x4>(SB, ro + 256 * bj); u32x4 w;
#pragma unroll
                    for (int n = 0; n < 2; ++n) { const f32x4 v = acc[ai][bj][m][n];
                        w[2 * n] = cvt_pk_bf16(v[0] * bf_lo(b[2 * n]), v[1] * bf_hi(b[2 * n])); w[2 * n + 1] = cvt_pk_bf16(v[2] * bf_lo(b[2 * n + 1]), v[3] * bf_hi(b[2 * n + 1])); }
                    stg<u32x4>(MG, ro + 256 * bj, w); }
                asm volatile("" ::: "memory"); }
    }
};
struct EpiOut {
    static constexpr bool HAS_MID = false;
    const float* x; float* out; float* oss;
    __device__ __forceinline__ void operator()(const f32x4 (&acc)[2][2][4][2], const Unit& u, int wr, int wc, int fr_, int fq_) const {
        const int fr = launder(fr_), fq = launder(fq_);
        const int row0 = u.pm * 256 + wr * 64 + fr;
        const unsigned ob = (unsigned)row0 * (D * 4) + (unsigned)(u.pn * 256 + 32 * wc + 4 * fq) * 4, sb = (unsigned)row0 * 64 + (unsigned)(u.pn * 4 + wc) * 4;
#pragma unroll
        for (int ai = 0; ai < 2; ++ai)
#pragma unroll
            for (int m = 0; m < 4; ++m) { const unsigned ro = ob + (unsigned)(ai * 128 + m * 16) * (D * 4); float ss = 0.f;
#pragma unroll
                for (int bj = 0; bj < 2; ++bj)
#pragma unroll
                    for (int n = 0; n < 2; ++n) { const f32x4 xv = ldg<f32x4>(x, ro + 512 * bj + 64 * n); const f32x4 o = xv + acc[ai][bj][m][n];
                        stg<f32x4>(out, ro + 512 * bj + 64 * n, o); ss += (o[0] * o[0] + o[1] * o[1]) + (o[2] * o[2] + o[3] * o[3]); }
                ss += __shfl_xor(ss, 16); ss += __shfl_xor(ss, 32); if (fq == 0) stg<float>(oss, sb + (ai * 128 + m * 16) * 64, ss);
                asm volatile("" ::: "memory"); }
    }
    __device__ __forceinline__ void mid(f32x4 (&)[2][2][4][2], const Unit&, int, int, int, int) const {}
};

__device__ __forceinline__ float wave_sum(float v) {
#pragma unroll
    for (int o = 1; o < 64; o <<= 1) v += __shfl_xor(v, o);
    return v;
}
__device__ __forceinline__ void tr_item(const float* W, int ldw, int srccol0, int k0, const float* kscale, bf16_t* dst, int ldd, int dstrow0, int dstcol0, bool perm, LAS float* scr, int lane) {
#pragma unroll 8
    for (int i = 0; i < 32; ++i) { const int kk = 2 * i + (lane >> 5); float v = W[(size_t)(k0 + kk) * ldw + srccol0 + (lane & 31)]; if (kscale) v *= kscale[k0 + kk]; scr[kk * 33 + (lane & 31)] = v; }
    asm volatile("s_waitcnt lgkmcnt(0)" ::: "memory");
    const int c = lane & 7;
#pragma unroll
    for (int j = 0; j < 4; ++j) { const int n = (lane >> 3) + 8 * j; const int sc = perm ? pg8::perm32(n) : n; const LAS float* s = scr + (8 * c) * 33 + sc;
        u32x4 o; o.x = cvt_pk_bf16(s[0 * 33], s[1 * 33]); o.y = cvt_pk_bf16(s[2 * 33], s[3 * 33]); o.z = cvt_pk_bf16(s[4 * 33], s[5 * 33]); o.w = cvt_pk_bf16(s[6 * 33], s[7 * 33]);
        *(u32x4*)(dst + (size_t)(dstrow0 + n) * ldd + dstcol0 + 8 * c) = o; }
    asm volatile("s_waitcnt lgkmcnt(0)" ::: "memory");
}
__device__ __forceinline__ int w1_src_col(int q) {
    const int tile = q >> 3, bj = (q >> 2) & 1, wc = q & 3;
    if (tile < 24) { const int type = tile >> 3, trel = tile & 7;
        const int seg = type == 0 ? (bj ? 2 : 0) : (type == 1 ? (bj ? 4 : 3) : (bj ? 6 : 5));
        return seg * D + 128 * trel + 32 * wc; }
    const int s = (tile - 24) >> 2, trel = (tile - 24) & 3; const int seg = s == 0 ? 1 : (s == 1 ? 7 : 8);
    return seg * D + 256 * trel + 128 * bj + 32 * wc;
}

struct Args { const float* in[11]; float* out; unsigned char* ws; int ph_lo, ph_hi; };

__global__ void __launch_bounds__(512, 2) mk_fwd(Args args) {
    extern __shared__ __attribute__((aligned(16))) unsigned char shm[];
    cg::grid_group grid = cg::this_grid();
    LAS unsigned char* lds = (LAS unsigned char*)shm;
    const int wave = __builtin_amdgcn_readfirstlane(threadIdx.x >> 6);
    const int G = gridDim.x, gw = blockIdx.x * 8 + wave, NGW = G * 8;
    unsigned char* ws = args.ws;
    const float* x = args.in[0]; const float* norm_g = args.in[1]; const float* w_in = args.in[2]; const float* v_norm_g = args.in[3];
    const float* w_sp = args.in[4]; const float* b_sp = args.in[5]; const float* conv_w = args.in[6];
    const float* w_pa = args.in[7]; const float* w_pb = args.in[8]; const float* w_out = args.in[9]; const float* fin_g = args.in[10];
    float* out = args.out;
    bf16_t* W1T = (bf16_t*)(ws + WS_W1T); bf16_t* B2T = (bf16_t*)(ws + WS_B2T); bf16_t* WOT = (bf16_t*)(ws + WS_WOT); bf16_t* WSB = (bf16_t*)(ws + WS_WSB);
    float* RINV = (float*)(ws + WS_RINV); float* VSS = (float*)(ws + WS_VSS); float* OSS = (float*)(ws + WS_OSS);
    bf16_t* XB = (bf16_t*)(ws + WS_XB); bf16_t* MG = XB; bf16_t* UZ = (bf16_t*)(ws + WS_UZ); bf16_t* BZ = (bf16_t*)(ws + WS_BZ);
    bf16_t* GV = (bf16_t*)(ws + WS_GV); bf16_t* HC = (bf16_t*)(ws + WS_HC); bf16_t* SA = (bf16_t*)(ws + WS_SA); bf16_t* SB = (bf16_t*)(ws + WS_SB);
    const int lo = args.ph_lo, hi = args.ph_hi;
#define IN(k) (lo <= (k) && (k) < hi)
#define BOTH(k) (IN(k) && IN((k) + 1))

    if (IN(0)) {
        const int lane = pg8::lane_id(), tid = wave * 64 + lane;
        LAS float* scr = (LAS float*)(lds + wave * 16384);
        constexpr int I_W1 = 288 * 16, I_B2 = 2 * 32 * 16, I_WO = 32 * 16, NITEMS = I_W1 + I_B2 + I_WO;
        for (int it = gw; it < NITEMS; it += NGW) {
            int r = it;
            if (r < I_W1) { const int q = r >> 4, kb = r & 15; tr_item(w_in, NPROJ, w1_src_col(q), 64 * kb, norm_g, W1T, D, 32 * q, 64 * kb, true, scr, lane); continue; } r -= I_W1;
            if (r < I_B2) { const int src = r >> 9, q = (r >> 4) & 31, kb = r & 15; tr_item(src ? w_pb : w_pa, D, 32 * q, 64 * kb, nullptr, B2T, 2 * D, 32 * q, src * D + 64 * kb, true, scr, lane); continue; } r -= I_B2;
            { const int q = r >> 4, kb = r & 15; tr_item(w_out, D, 32 * q, 64 * kb, nullptr, WOT, D, 32 * q, 64 * kb, false, scr, lane); }
        }
        for (int i = blockIdx.x * 512 + tid; i < NGRP * SCH * SCH; i += G * 512) { const int t = (i >> 7) & 127, s = i & 127; const float v = s <= t ? w_sp[i] : 0.f; WSB[i] = (bf16_t)(cvt_pk_bf16(v, 0.f) & 0xffffu); }
        for (int m = gw; m < M; m += NGW) {
            const f32x4* xr = (const f32x4*)(x + (size_t)m * D) + lane; f32x4 v[4]; float s = 0.f;
#pragma unroll
            for (int j = 0; j < 4; ++j) { v[j] = xr[64 * j]; s += (v[j].x * v[j].x + v[j].y * v[j].y) + (v[j].z * v[j].z + v[j].w * v[j].w); }
            s = wave_sum(s); if (lane == 0) RINV[m] = 1.0f / sqrtf(s * (1.0f / D) + EPS);
            u32x2* o8 = (u32x2*)(XB + (size_t)m * D) + lane;
#pragma unroll
            for (int j = 0; j < 4; ++j) o8[64 * j] = (u32x2){cvt_pk_bf16(v[j].x, v[j].y), cvt_pk_bf16(v[j].z, v[j].w)};
        }
        if (BOTH(0)) grid.sync();
    }

    if (IN(1)) {
        pg8::Gemm g{XB, W1T, M, NPROJ, D, D, D, 1 << 30, 0}; pg8::StaticOrder S; S.init(M, NPROJ, G, (int)blockIdx.x);
        EpiProj E{RINV, UZ, GV, HC, BZ, SA, SB, VSS};
        pg8::gemm_phase<EpiProj, pg8::StaticOrder>(lds, wave, g, S, E);
        if (BOTH(1)) grid.sync();
    }

    if (IN(2)) {
        constexpr int VP = 288;
        LAS unsigned char* vs = lds; LAS float* rvs = (LAS float*)(lds + 128 * VP);
        const int lane = pg8::lane_id(), tid = wave * 64 + lane;
        const int fr = lane & 15, fq = lane >> 4, cc = tid & 15, sr = tid >> 4;
        typedef short v4i16_t __attribute__((ext_vector_type(4)));
        const int nks = (wave >> 1) + 1;
        const u32x4 z4 = (u32x4){0u, 0u, 0u, 0u};
        for (int item = blockIdx.x; item < (M / SCH) * NGRP; item += G) {
            const int chunk = item >> 3, grp = item & 7, row0 = chunk * SCH, chb = grp * GDIM, ch = chb + 8 * cc;
            f32x4 pa = (f32x4){0.f, 0.f, 0.f, 0.f}, pb = pa, pc = pa, pd = pa;
            if (tid < 128) { const f32x4* p = (const f32x4*)(VSS + (size_t)(row0 + tid) * 16); pa = p[0]; pb = p[1]; pc = p[2]; pd = p[3]; }
            u32x4 gvw[4], h0[4], h1[4], h2[4], bzv[4];
#pragma unroll
            for (int i = 0; i < 4; ++i) { const int row = row0 + sr + 32 * i, tseq = row & (SEQ - 1); const size_t off = (size_t)row * D + ch;
                gvw[i] = *(const u32x4*)(GV + off); h0[i] = *(const u32x4*)(HC + off); h1[i] = tseq >= 1 ? *(const u32x4*)(HC + off - D) : z4; h2[i] = tseq >= 2 ? *(const u32x4*)(HC + off - 2 * D) : z4;
                bzv[i] = *(const u32x4*)(BZ + off); }
            const int t = 16 * wave + fr; bf16_t* uzp = UZ + (size_t)(row0 + t) * D + chb + 4 * fq;
            u32x2 uzv[8];
#pragma unroll
            for (int cb = 0; cb < 8; ++cb) uzv[cb] = *(const u32x2*)(uzp + 16 * cb);
            const bf16_t* wrow = WSB + ((size_t)(grp * SCH + t) * SCH + 8 * fq);
            bf16x8 afr[4];
#pragma unroll
            for (int ks = 0; ks < 4; ++ks) afr[ks] = ks < nks ? *(const bf16x8*)(wrow + 32 * ks) : (bf16x8){0, 0, 0, 0, 0, 0, 0, 0};
            const float bias = b_sp[grp * SCH + t];
            const f32x4 g0 = *(const f32x4*)(v_norm_g + ch), g1 = *(const f32x4*)(v_norm_g + ch + 4);
            const f32x4 w0a = *(const f32x4*)(conv_w + ch), w0b = *(const f32x4*)(conv_w + ch + 4), w1a = *(const f32x4*)(conv_w + D + ch), w1b = *(const f32x4*)(conv_w + D + ch + 4),
                        w2a = *(const f32x4*)(conv_w + 2 * D + ch), w2b = *(const f32x4*)(conv_w + 2 * D + ch + 4);
            if (tid < 128) { const float s = ((pa.x + pa.y) + (pa.z + pa.w)) + ((pb.x + pb.y) + (pb.z + pb.w)) + ((pc.x + pc.y) + (pc.z + pc.w)) + ((pd.x + pd.y) + (pd.z + pd.w));
                rvs[tid] = 1.0f / sqrtf(s * (1.0f / D) + EPS); }
            __syncthreads();
#pragma unroll
            for (int i = 0; i < 4; ++i) { const int sI = sr + 32 * i; const u32x4 w = gvw[i]; const float rv = rvs[sI];
                u32x4 o; o.x = cvt_pk_bf16(bf_lo(w.x) * rv * g0.x, bf_hi(w.x) * rv * g0.y); o.y = cvt_pk_bf16(bf_lo(w.y) * rv * g0.z, bf_hi(w.y) * rv * g0.w);
                o.z = cvt_pk_bf16(bf_lo(w.z) * rv * g1.x, bf_hi(w.z) * rv * g1.y); o.w = cvt_pk_bf16(bf_lo(w.w) * rv * g1.z, bf_hi(w.w) * rv * g1.w);
                *(LAS u32x4*)(vs + sI * VP + cc * 16) = o; }
            __syncthreads();
            f32x4 acc[8];
#pragma unroll
            for (int cb = 0; cb < 8; ++cb) acc[cb] = (f32x4){0.f, 0.f, 0.f, 0.f};
            const LAS unsigned char* vb = vs + (8 * fq + (fr >> 2)) * VP + (fr & 3) * 8;
#pragma unroll
            for (int ks = 0; ks < 4; ++ks) if (ks < nks) {
#pragma unroll
                for (int cb = 0; cb < 8; ++cb) {
                    const v4i16_t l0 = __builtin_amdgcn_ds_read_tr16_b64_v4i16((LAS v4i16_t*)(vb + (32 * ks) * VP + cb * 32));
                    const v4i16_t l1 = __builtin_amdgcn_ds_read_tr16_b64_v4i16((LAS v4i16_t*)(vb + (32 * ks + 4) * VP + cb * 32));
                    const bf16x8 bfr = __builtin_shufflevector(l0, l1, 0, 1, 2, 3, 4, 5, 6, 7);
                    acc[cb] = __builtin_amdgcn_mfma_f32_16x16x32_bf16(bfr, afr[ks], acc[cb], 0, 0, 0);
                }
            }
#pragma unroll
            for (int cb = 0; cb < 8; ++cb) { const u32x2 uz = uzv[cb]; const f32x4 mx = acc[cb] + bias;
                *(u32x2*)(uzp + 16 * cb) = (u32x2){cvt_pk_bf16(bf_lo(uz.x) * mx[0], bf_hi(uz.x) * mx[1]), cvt_pk_bf16(bf_lo(uz.y) * mx[2], bf_hi(uz.y) * mx[3])}; }
#pragma unroll
            for (int i = 0; i < 4; ++i) { const size_t off = (size_t)(row0 + sr + 32 * i) * D + ch; const u32x4 bz = bzv[i], a0 = h0[i], a1 = h1[i], a2 = h2[i];
                u32x4 o;
                o.x = cvt_pk_bf16(bf_lo(bz.x) * (w0a.x * bf_lo(a2.x) + w1a.x * bf_lo(a1.x) + w2a.x * bf_lo(a0.x)), bf_hi(bz.x) * (w0a.y * bf_hi(a2.x) + w1a.y * bf_hi(a1.x) + w2a.y * bf_hi(a0.x)));
                o.y = cvt_pk_bf16(bf_lo(bz.y) * (w0a.z * bf_lo(a2.y) + w1a.z * bf_lo(a1.y) + w2a.z * bf_lo(a0.y)), bf_hi(bz.y) * (w0a.w * bf_hi(a2.y) + w1a.w * bf_hi(a1.y) + w2a.w * bf_hi(a0.y)));
                o.z = cvt_pk_bf16(bf_lo(bz.z) * (w0b.x * bf_lo(a2.z) + w1b.x * bf_lo(a1.z) + w2b.x * bf_lo(a0.z)), bf_hi(bz.z) * (w0b.y * bf_hi(a2.z) + w1b.y * bf_hi(a1.z) + w2b.y * bf_hi(a0.z)));
                o.w = cvt_pk_bf16(bf_lo(bz.w) * (w0b.z * bf_lo(a2.w) + w1b.z * bf_lo(a1.w) + w2b.z * bf_lo(a0.w)), bf_hi(bz.w) * (w0b.w * bf_hi(a2.w) + w1b.w * bf_hi(a1.w) + w2b.w * bf_hi(a0.w)));
                *(u32x4*)(BZ + off) = o; }
            __syncthreads();
        }
        if (BOTH(2)) grid.sync();
    }

    if (IN(3)) {
        pg8::Gemm g{UZ, B2T, M, D, 2 * D, D, 2 * D, 16, (long)(WS_BZ - WS_UZ) - 2 * D}; pg8::StaticOrder S; S.init(M, D, G, (int)blockIdx.x);
        EpiMerge E{SA, SB, MG};
        pg8::gemm_phase<EpiMerge, pg8::StaticOrder>(lds, wave, g, S, E);
        if (BOTH(3)) grid.sync();
    }

    if (IN(4)) {
        pg8::Gemm g{MG, WOT, M, D, D, D, D, 1 << 30, 0}; pg8::StaticOrder S; S.init(M, D, G, (int)blockIdx.x);
        EpiOut E{x, out, OSS};
        pg8::gemm_phase<EpiOut, pg8::StaticOrder>(lds, wave, g, S, E);
        if (BOTH(4)) grid.sync();
    }

    if (IN(5)) {
        const int lane = pg8::lane_id();
        for (int m = gw; m < M; m += NGW) {
            float s = OSS[(size_t)m * 16 + (lane & 15)];
            s += __shfl_xor(s, 1); s += __shfl_xor(s, 2); s += __shfl_xor(s, 4); s += __shfl_xor(s, 8);
            const float rr = 1.0f / sqrtf(s * (1.0f / D) + EPS);
            f32x4* orow = (f32x4*)(out + (size_t)m * D) + lane; const f32x4* gp = (const f32x4*)fin_g + lane;
#pragma unroll
            for (int j = 0; j < 4; ++j) { const f32x4 v = orow[64 * j]; orow[64 * j] = v * rr * gp[64 * j]; }
        }
    }
#undef IN
#undef BOTH
}

extern "C" void kernel_launch(void* const* d_in, const int* in_sizes, int n_in, void* d_out, int out_size, void* d_ws, size_t ws_size, hipStream_t stream) {
    static int grid = 0;
    if (grid == 0) {
        if (n_in != 11 || in_sizes[0] != M * D || out_size != M * D || ws_size < WS_END) { fprintf(stderr, "kernel_launch: unexpected shapes (n_in %d, in0 %d, out %d, ws %zu); nothing launched\n", n_in, n_in > 0 ? in_sizes[0] : -1, out_size, ws_size); grid = -1; return; }
        int dev = 0, cus = 0, per_cu = 0;
        if (hipGetDevice(&dev) != hipSuccess || hipDeviceGetAttribute(&cus, hipDeviceAttributeMultiprocessorCount, dev) != hipSuccess) { grid = -1; return; }
        if (hipFuncSetAttribute((const void*)mk_fwd, hipFuncAttributeMaxDynamicSharedMemorySize, LDS_BYTES) != hipSuccess) { fprintf(stderr, "kernel_launch: hipFuncSetAttribute failed\n"); grid = -1; return; }
        if (hipOccupancyMaxActiveBlocksPerMultiprocessor(&per_cu, (const void*)mk_fwd, 512, LDS_BYTES) != hipSuccess || per_cu < 1) { fprintf(stderr, "kernel_launch: occupancy query says %d\n", per_cu); per_cu = 1; }
        (void)hipGetLastError();
        grid = cus * 1;
    }
    if (grid < 0) return;
    Args a{};
    for (int i = 0; i < 11; ++i) a.in[i] = (const float*)d_in[i];
    a.out = (float*)d_out; a.ws = (unsigned char*)d_ws;
#if MK_N_LAUNCHES == 1
    a.ph_lo = 0; a.ph_hi = 6;
    void* kargs[] = {&a};
    hipError_t e = hipLaunchCooperativeKernel((const void*)mk_fwd, dim3(grid), dim3(512), kargs, LDS_BYTES, stream);
    if (e != hipSuccess) fprintf(stderr, "kernel_launch: cooperative launch failed: %s (grid %d)\n", hipGetErrorString(e), grid);
#else
    for (int p = 0; p < 6; ++p) { a.ph_lo = p; a.ph_hi = p + 1; hipLaunchKernelGGL(mk_fwd, dim3(grid), dim3(512), LDS_BYTES, stream, a); }
#endif
}
```
